# Optimizing an MI355X kernel written in HIP

```python
import math
import jax, jax.numpy as jnp
from jax import lax
import numpy as np

D_MODEL = 1024
BATCH = 8
SEQ = 4096
DEPTH = 4

N_META = 16
BLOCK = 128
PAD = (-N_META) % BLOCK
MLA_HEADS = 8
MLA_Q_RANK = 256
MLA_KV_RANK = 128
MLA_NOPE = 64
MLA_ROPE = 32
MLA_V = 64
ROPE_THETA = 10000.0
SWA_HEADS = 8
SWA_KV_HEADS = 2
SWA_GROUP = SWA_HEADS // SWA_KV_HEADS
SWA_HEAD_DIM = 64
WINDOW = 128
MIX_A = MLA_HEADS * MLA_V
MIX_B = SWA_HEADS * SWA_HEAD_DIM
MIX_WIDTH = MIX_A + MIX_B
IN_SIZES = [MLA_Q_RANK, MLA_KV_RANK, MLA_ROPE,
            SWA_HEADS * SWA_HEAD_DIM, SWA_KV_HEADS * SWA_HEAD_DIM, SWA_KV_HEADS * SWA_HEAD_DIM]
IN_COLS = sum(IN_SIZES)
IN_SPLITS = [int(v) for v in np.cumsum(IN_SIZES)[:-1]]
D_FF = -(-8 * D_MODEL // (3 * 256)) * 256
ALPHA = (2 * DEPTH) ** 0.25
BETA = (8 * DEPTH) ** -0.25
LN_EPS = 1e-5
RMS_EPS = 1e-6
NEG = -1e30

kernel_name = "hymba_mla_swa_deepnorm_trunk"


def layer_norm(x, g, b):
    xf = x.astype(jnp.float32)
    mu = jnp.mean(xf, -1, keepdims=True)
    var = jnp.mean(jnp.square(xf - mu), -1, keepdims=True)
    return ((xf - mu) * lax.rsqrt(var + LN_EPS) * g + b).astype(x.dtype)


def rms_norm(x, g):
    xf = x.astype(jnp.float32)
    return (xf * lax.rsqrt(jnp.mean(jnp.square(xf), -1, keepdims=True) + RMS_EPS) * g).astype(x.dtype)


def rope_tables(T):
    pos = jnp.arange(T, dtype=jnp.float32)
    inv = ROPE_THETA ** (-jnp.arange(0, MLA_ROPE, 2, dtype=jnp.float32) / MLA_ROPE)
    ang = pos[:, None] * inv[None, :]
    return jnp.cos(ang), jnp.sin(ang)


def apply_rope(x, cos, sin):
    x1, x2 = jnp.split(x.astype(jnp.float32), 2, axis=-1)
    return jnp.concatenate([x1 * cos - x2 * sin, x2 * cos + x1 * sin], -1).astype(x.dtype)


def alibi_slopes():
    h = jnp.arange(1, SWA_HEADS + 1, dtype=jnp.float32)
    return jnp.exp2(-8.0 * h / SWA_HEADS)


def pad_front(a):
    return jnp.pad(a, [(0, 0), (PAD, 0)] + [(0, 0)] * (a.ndim - 2))


def mla_mixer(q_c, kv_c, k_r, q_norm_g, w_uq, kv_norm_g, w_ukv, cos, sin):
    B, T, _ = q_c.shape
    q = (rms_norm(q_c, q_norm_g) @ w_uq).reshape(B, T, MLA_HEADS, MLA_NOPE + MLA_ROPE)
    q_nope, q_rope = q[..., :MLA_NOPE], q[..., MLA_NOPE:]
    q_rope = apply_rope(q_rope, cos[:, None, :], sin[:, None, :])
    kv = (rms_norm(kv_c, kv_norm_g) @ w_ukv).reshape(B, T, MLA_HEADS, MLA_NOPE + MLA_V)
    k_nope, v = kv[..., :MLA_NOPE], kv[..., MLA_NOPE:]
    k_rope = apply_rope(k_r, cos, sin)
    q_nope, q_rope, k_nope, k_rope, v = (pad_front(a) for a in (q_nope, q_rope, k_nope, k_rope, v))
    Lp = T + PAD
    nb = Lp // BLOCK
    key_pos = jnp.arange(Lp)
    key_valid = key_pos >= PAD
    scale = (MLA_NOPE + MLA_ROPE) ** -0.5
    qn_b = q_nope.reshape(B, nb, BLOCK, MLA_HEADS, MLA_NOPE).transpose(1, 0, 2, 3, 4)
    qr_b = q_rope.reshape(B, nb, BLOCK, MLA_HEADS, MLA_ROPE).transpose(1, 0, 2, 3, 4)

    def query_block(args):
        i, qn, qr = args
        s = (jnp.einsum('bqhd,bkhd->bhqk', qn, k_nope)
             + jnp.einsum('bqhr,bkr->bhqk', qr, k_rope)).astype(jnp.float32) * scale
        q_pos = i * BLOCK + jnp.arange(BLOCK)
        mask = (key_pos[None, :] <= q_pos[:, None]) & key_valid[None, :]
        p = jax.nn.softmax(jnp.where(mask, s, NEG), axis=-1)
        return jnp.einsum('bhqk,bkhd->bqhd', p.astype(v.dtype), v)

    out = lax.map(query_block, (jnp.arange(nb), qn_b, qr_b))
    out = out.transpose(1, 0, 2, 3, 4).reshape(B, Lp, MIX_A)
    return out[:, PAD:]


def swa_mixer(q, k, v, sinks, slopes):
    B, T, _ = q.shape
    q = pad_front(q.reshape(B, T, SWA_KV_HEADS, SWA_GROUP, SWA_HEAD_DIM))
    k = pad_front(k.reshape(B, T, SWA_KV_HEADS, SWA_HEAD_DIM))
    v = pad_front(v.reshape(B, T, SWA_KV_HEADS, SWA_HEAD_DIM))
    Lp = T + PAD
    nb = Lp // BLOCK
    qb = q.reshape(B, nb, BLOCK, SWA_KV_HEADS, SWA_GROUP, SWA_HEAD_DIM)
    kb = k.reshape(B, nb, BLOCK, SWA_KV_HEADS, SWA_HEAD_DIM)
    vb = v.reshape(B, nb, BLOCK, SWA_KV_HEADS, SWA_HEAD_DIM)
    shift = [(0, 0), (1, 0), (0, 0), (0, 0), (0, 0)]
    k_band = jnp.concatenate([jnp.pad(kb, shift)[:, :-1], kb], axis=2)
    v_band = jnp.concatenate([jnp.pad(vb, shift)[:, :-1], vb], axis=2)
    s = jnp.einsum('bnqkgd,bnskd->bnkgqs', qb, k_band).astype(jnp.float32) * (SWA_HEAD_DIM ** -0.5)
    dist = (BLOCK + jnp.arange(BLOCK))[:, None] - jnp.arange(2 * BLOCK)[None, :]
    band = (dist >= 0) & (dist < WINDOW)
    key_idx = jnp.arange(nb)[:, None] * BLOCK - BLOCK + jnp.arange(2 * BLOCK)[None, :]
    mask = band[None] & (key_idx >= PAD)[:, None, :]
    alibi = -slopes.reshape(SWA_KV_HEADS, SWA_GROUP)[:, :, None, None] * dist.astype(jnp.float32)
    s = jnp.where(mask[None, :, None, None], s + alibi, NEG)
    sink = sinks.astype(jnp.float32).reshape(SWA_KV_HEADS, SWA_GROUP)[None, None, :, :, None, None]
    m = jnp.maximum(jnp.max(s, -1, keepdims=True), sink)
    e = jnp.exp(s - m)
    p = e / (jnp.sum(e, -1, keepdims=True) + jnp.exp(sink - m))
    out = jnp.einsum('bnkgqs,bnskd->bnqkgd', p.astype(v_band.dtype), v_band)
    return out.reshape(B, Lp, MIX_B)[:, PAD:]


def setup_inputs(seed: int = 0) -> dict:
    key = jax.random.key(seed)
    ks = jax.random.split(key, 20)
    nrm = lambda k, shape, scale: jax.random.normal(k, shape, jnp.float32) * scale
    gain = lambda k, shape: 1.0 + nrm(k, shape, 0.02)
    return {
        "x": nrm(ks[0], (BATCH, SEQ, D_MODEL), 1.0),
        "meta_tokens": nrm(ks[1], (N_META, D_MODEL), 1.0),
        "ln_in_g": gain(ks[2], (D_MODEL,)),
        "ln_in_b": nrm(ks[3], (D_MODEL,), 0.02),
        "w_in": nrm(ks[4], (DEPTH, D_MODEL, IN_COLS), D_MODEL ** -0.5),
        "q_norm_g": gain(ks[5], (DEPTH, MLA_Q_RANK)),
        "w_uq": nrm(ks[6], (DEPTH, MLA_Q_RANK, MLA_HEADS * (MLA_NOPE + MLA_ROPE)), MLA_Q_RANK ** -0.5),
        "kv_norm_g": gain(ks[7], (DEPTH, MLA_KV_RANK)),
        "w_ukv": nrm(ks[8], (DEPTH, MLA_KV_RANK, MLA_HEADS * (MLA_NOPE + MLA_V)), MLA_KV_RANK ** -0.5),
        "attn_sinks": nrm(ks[9], (DEPTH, SWA_HEADS), 1.0),
        "grp_norm_a": gain(ks[10], (DEPTH, MIX_A)),
        "grp_norm_b": gain(ks[11], (DEPTH, MIX_B)),
        "w_out": nrm(ks[12], (DEPTH, MIX_WIDTH, D_MODEL), BETA * MIX_WIDTH ** -0.5),
        "ln1_g": gain(ks[13], (DEPTH, D_MODEL)),
        "ln1_b": nrm(ks[14], (DEPTH, D_MODEL), 0.02),
        "w_gate_up": nrm(ks[15], (DEPTH, D_MODEL, 2 * D_FF), D_MODEL ** -0.5),
        "w_down": nrm(ks[16], (DEPTH, D_FF, D_MODEL), BETA * D_FF ** -0.5),
        "ln2_g": gain(ks[17], (DEPTH, D_MODEL)),
        "ln2_b": nrm(ks[18], (DEPTH, D_MODEL), 0.02),
    }


def reference(x, meta_tokens, ln_in_g, ln_in_b, w_in, q_norm_g, w_uq, kv_norm_g, w_ukv,
              attn_sinks, grp_norm_a, grp_norm_b, w_out, ln1_g, ln1_b, w_gate_up, w_down,
              ln2_g, ln2_b):
    B = x.shape[0]
    meta = jnp.broadcast_to(meta_tokens[None].astype(x.dtype), (B, N_META, D_MODEL))
    h = layer_norm(jnp.concatenate([meta, x], axis=1), ln_in_g, ln_in_b)
    T = h.shape[1]
    cos, sin = rope_tables(T)
    slopes = alibi_slopes()
    for l in range(DEPTH):
        proj = h @ w_in[l]
        q_c, kv_c, k_r, sq, sk, sv = jnp.split(proj, IN_SPLITS, axis=-1)
        o_a = mla_mixer(q_c, kv_c, k_r, q_norm_g[l], w_uq[l], kv_norm_g[l], w_ukv[l], cos, sin)
        o_b = swa_mixer(sq, sk, sv, attn_sinks[l], slopes)
        o = jnp.concatenate([rms_norm(o_a, grp_norm_a[l]), rms_norm(o_b, grp_norm_b[l])], axis=-1)
        h = layer_norm(ALPHA * h + o @ w_out[l], ln1_g[l], ln1_b[l])
        gate, up = jnp.split(h @ w_gate_up[l], 2, axis=-1)
        f = (jax.nn.silu(gate) * up) @ w_down[l]
        h = layer_norm(ALPHA * h + f, ln2_g[l], ln2_b[l])
    return h[:, N_META:]
```

```cpp
#include <hip/hip_runtime.h>
#include <hip/hip_cooperative_groups.h>
#include <cstdio>
#include <cstdint>
namespace cg = cooperative_groups;

#ifndef ONLY
#define ONLY -1
#endif
#define EN(x) (ONLY < 0 || ONLY == (x))
#ifndef MK_SINGLE
#define MK_SINGLE 0
#endif

__device__ __forceinline__ int ltid() { int t = threadIdx.x; asm volatile("" : "+v"(t)); return t; }
__device__ __forceinline__ int lbid() { int t = blockIdx.x; asm volatile("" : "+s"(t)); return t; }
__device__ __forceinline__ int lgrid() { int t = gridDim.x; asm volatile("" : "+s"(t)); return t; }
namespace pg8 {
#define PG8_LAS __attribute__((address_space(3)))
typedef unsigned short bf16_t;
typedef short bf16x8 __attribute__((ext_vector_type(8)));
typedef float f32x4 __attribute__((ext_vector_type(4)));
typedef unsigned u32x4 __attribute__((ext_vector_type(4)));
constexpr int BM = 256, BK = 64, HALF = 128, HTB = HALF * BK * 2  , STAGE_BYTES = 8 * HTB, NXCD = 8, WGM = 8;

__host__ __device__ __forceinline__ int lds_byte(int r, int c) { const int st = (r >> 4) * 2 + (c >> 5), rr = r & 15, cc = c & 31, ob = rr * 64 + cc * 2; return st * 1024 + (ob ^ (((ob >> 9) & 1) << 5)); }
__host__ __device__ __forceinline__ void stage_rc(int b, int& R, int& C) { const int st = b / 1024, sb = b % 1024, swz = sb ^ (((sb >> 9) & 1) << 5); R = (st >> 1) * 16 + swz / 64; C = (st & 1) * 32 + (swz % 64) / 2; }
__host__ __device__ __forceinline__ int perm32(int rho) { const int n = rho >> 4, i = rho & 15; return 8 * (i >> 2) + 4 * n + (i & 3); }

struct Unit { int pm, pn; };
struct Gemm { const bf16_t* A; const bf16_t* Bt; int M, N, K, lda; };

struct StaticOrder {
    int nM, nN, nwg, G, c;
    __host__ __device__ void init(int M, int N, int G_, int c_) { nM = M / BM; nN = N / BM; nwg = nM * nN; G = G_; c = c_; }
    __host__ __device__ bool next(int i, Unit& u) const {
        const long L = (long)i * G + c; if (L >= nwg) return false;
        int wgid = (int)L; { const int q = nwg / NXCD, r = nwg % NXCD, xcd = wgid % NXCD, off = wgid / NXCD; wgid = (xcd < r ? xcd * (q + 1) : r * (q + 1) + (xcd - r) * q) + off; }
        const int nig = WGM * nN, gid = wgid / nig, fm = gid * WGM, gsz = (nM - fm) < WGM ? (nM - fm) : WGM;
        u.pm = fm + ((wgid % nig) % gsz); u.pn = (wgid % nig) / gsz; return true;
    }
    __device__ __forceinline__ void a_ready(const Unit&) const {}
    __device__ __forceinline__ void done(const Unit&) const {}
};
__device__ __forceinline__ unsigned cvt_pk_bf16(float lo, float hi) { unsigned r; asm volatile("v_cvt_pk_bf16_f32 %0, %1, %2" : "=v"(r) : "v"(lo), "v"(hi)); return r; }

template <class Epi, class Sched, bool ALIGN_EPI = false, bool SP2 = false>
__device__ __forceinline__ void gemm_phase(PG8_LAS unsigned char* lds, const Gemm g, const Sched& S, const Epi& E) {
    const int tid = ltid(), wid = __builtin_amdgcn_readfirstlane(tid >> 6), lane = tid & 63, wr = wid >> 2, wc = wid & 3, fr = lane & 15, fq = lane >> 4;
    const int K = g.K, nt = K / BK;
    unsigned voffA[2], voffB[2];
#pragma unroll
    for (int i = 0; i < 2; ++i) { int R, C; stage_rc(tid * 16 + i * 8192, R, C); const int Rb = Epi::PERM ? ((R & ~31) + perm32(R & 31)) : R;
        voffA[i] = (unsigned)(R * g.lda + C) * 2u; voffB[i] = (unsigned)(Rb * K + C) * 2u; }
    const size_t kstep = (size_t)(BK * 2);
    const size_t hstepA = (size_t)HALF * g.lda * 2, hstepB = (size_t)HALF * K * 2;
    const size_t tstepA = 2 * hstepA, tstepB = 2 * hstepB;
    const unsigned ldsw = (unsigned)wid * 1024u;
    const int aoff = lds_byte(wr * 64 + fr, fq * 8), boff = lds_byte(wc * 32 + fr, fq * 8);
#define PG8_SA(b, h) (((b) * 2 + (h)) * HTB)
#define PG8_SB(b, h) ((4 + (b) * 2 + (h)) * HTB)
#define PG8_STAGE(bufoff, gbase, voff) do { _Pragma("unroll") for (int _i = 0; _i < 2; ++_i) \
        __builtin_amdgcn_global_load_lds((const unsigned*)((const char*)(gbase) + (voff)[_i]), (PG8_LAS unsigned*)(lds + (bufoff) + ldsw + _i * 8192), 16, 0, 0); } while (0)
#define PG8_LDA(dst, b, h) do { _Pragma("unroll") for (int m = 0; m < 4; ++m) _Pragma("unroll") for (int k = 0; k < 2; ++k) dst[m][k] = *(const PG8_LAS bf16x8*)(lds + PG8_SA(b, h) + aoff + m * 2048 + k * 1024); } while (0)
#define PG8_LDB(dst, b, h) do { _Pragma("unroll") for (int n = 0; n < 2; ++n) _Pragma("unroll") for (int k = 0; k < 2; ++k) dst[n][k] = *(const PG8_LAS bf16x8*)(lds + PG8_SB(b, h) + boff + n * 2048 + k * 1024); } while (0)
#define PG8_MMA(ai, bj, At, Bt) do { __builtin_amdgcn_s_setprio(1); _Pragma("unroll") for (int m = 0; m < 4; ++m) _Pragma("unroll") for (int n = 0; n < 2; ++n) _Pragma("unroll") for (int k = 0; k < 2; ++k) \
        acc[ai][bj][m][n] = __builtin_amdgcn_mfma_f32_16x16x32_bf16(Bt[n][k], At[m][k], acc[ai][bj][m][n], 0, 0, 0); __builtin_amdgcn_s_setprio(0); } while (0)
#define PG8_WAIT_V(n) asm volatile("s_waitcnt vmcnt(" #n ")" ::: "memory")
#define PG8_WAIT_L(n) asm volatile("s_waitcnt lgkmcnt(" #n ")" ::: "memory")
#define PG8_BAR __builtin_amdgcn_s_barrier()
#define PG8_SCHED __builtin_amdgcn_sched_barrier(0)
    Unit cur, nxt; int ui = 0;
    if (!S.next(0, cur)) return;
    f32x4 acc[2][2][4][2];
#pragma unroll
    for (int a = 0; a < 2; ++a)
#pragma unroll
        for (int b = 0; b < 2; ++b)
#pragma unroll
            for (int m = 0; m < 4; ++m)
#pragma unroll
                for (int n = 0; n < 2; ++n) acc[a][b][m][n] = (f32x4){0.f, 0.f, 0.f, 0.f};
    bf16x8 At[4][2], B0[2][2], B1[2][2];
    const char* cA = (const char*)g.A + (size_t)cur.pm * tstepA; const char* cB = (const char*)g.Bt + (size_t)cur.pn * tstepB;
    S.a_ready(cur);
    if constexpr (SP2) {
        PG8_STAGE(PG8_SB(0, 0), cB, voffB); PG8_STAGE(PG8_SB(0, 1), cB + hstepB, voffB); PG8_STAGE(PG8_SA(0, 0), cA, voffA); PG8_STAGE(PG8_SA(0, 1), cA + hstepA, voffA);
        if (wr == 1) PG8_BAR;
        PG8_WAIT_V(2); PG8_BAR;
        PG8_STAGE(PG8_SB(1, 0), cB + kstep, voffB); PG8_STAGE(PG8_SA(1, 0), cA + kstep, voffA); PG8_STAGE(PG8_SB(1, 1), cB + hstepB + kstep, voffB);
        PG8_WAIT_V(6); PG8_BAR;
    } else {
        PG8_STAGE(PG8_SB(0, 0), cB, voffB); PG8_STAGE(PG8_SA(0, 0), cA, voffA); PG8_STAGE(PG8_SB(0, 1), cB + hstepB, voffB); PG8_STAGE(PG8_SA(0, 1), cA + hstepA, voffA);
        if (wr == 1) PG8_BAR;
        PG8_WAIT_V(4); PG8_BAR;
        PG8_STAGE(PG8_SB(1, 0), cB + kstep, voffB); PG8_STAGE(PG8_SA(1, 0), cA + kstep, voffA); PG8_STAGE(PG8_SB(1, 1), cB + hstepB + kstep, voffB);
        PG8_WAIT_V(6); PG8_BAR;
    }
    for (;;) {
        const bool has_next = S.next(ui + 1, nxt);
        const char* nA = has_next ? (const char*)g.A + (size_t)nxt.pm * tstepA : cA; const char* nB = has_next ? (const char*)g.Bt + (size_t)nxt.pn * tstepB : cB;
        for (int t = 0; t < nt; t += 2) {
            const bool last = (t == nt - 2);
            const char* a1 = cA + (size_t)(t + 1) * kstep;
            const char* a2 = last ? nA : cA + (size_t)(t + 2) * kstep; const char* b2 = last ? nB : cB + (size_t)(t + 2) * kstep;
            const char* a3 = a2 + kstep; const char* b3 = b2 + kstep;
            if (last && has_next) S.a_ready(nxt);
            if constexpr (SP2) {
            PG8_LDB(B0, 0, 0); PG8_LDB(B1, 0, 1); PG8_SCHED; PG8_LDA(At, 0, 0); PG8_STAGE(PG8_SA(1, 1), a1 + hstepA, voffA);
            PG8_WAIT_V(8); PG8_WAIT_L(0); PG8_BAR; PG8_MMA(0, 0, At, B0); PG8_MMA(0, 1, At, B1); PG8_BAR; PG8_SCHED;
            PG8_LDA(At, 0, 1); PG8_STAGE(PG8_SB(0, 0), b2, voffB); PG8_STAGE(PG8_SB(0, 1), b2 + hstepB, voffB); PG8_STAGE(PG8_SA(0, 0), a2, voffA);
            PG8_WAIT_V(8); PG8_WAIT_L(0); PG8_BAR; PG8_MMA(1, 0, At, B0); PG8_MMA(1, 1, At, B1); PG8_BAR; PG8_SCHED;
            PG8_LDB(B0, 1, 0); PG8_LDB(B1, 1, 1); PG8_SCHED; PG8_LDA(At, 1, 0); PG8_STAGE(PG8_SA(0, 1), a2 + hstepA, voffA);
            PG8_WAIT_V(8); PG8_WAIT_L(0); PG8_BAR; PG8_MMA(0, 0, At, B0); PG8_MMA(0, 1, At, B1); PG8_BAR; PG8_SCHED;
            PG8_LDA(At, 1, 1); PG8_STAGE(PG8_SB(1, 0), b3, voffB); PG8_STAGE(PG8_SB(1, 1), b3 + hstepB, voffB); PG8_STAGE(PG8_SA(1, 0), a3, voffA);
            PG8_WAIT_V(8); PG8_WAIT_L(0); PG8_BAR; PG8_MMA(1, 0, At, B0); PG8_MMA(1, 1, At, B1); PG8_BAR; PG8_SCHED;
            } else {
            PG8_LDB(B0, 0, 0); PG8_SCHED; PG8_LDA(At, 0, 0); PG8_STAGE(PG8_SA(1, 1), a1 + hstepA, voffA);
            PG8_WAIT_L(8); PG8_BAR; PG8_WAIT_L(0); PG8_MMA(0, 0, At, B0); PG8_BAR; PG8_SCHED;
            PG8_LDB(B1, 0, 1); PG8_STAGE(PG8_SB(0, 0), b2, voffB);
            PG8_BAR; PG8_WAIT_L(0); PG8_MMA(0, 1, At, B1); PG8_BAR;
            PG8_LDA(At, 0, 1); PG8_STAGE(PG8_SA(0, 0), a2, voffA);
            PG8_BAR; PG8_WAIT_L(0); PG8_MMA(1, 0, At, B0); PG8_BAR; PG8_SCHED;
            PG8_STAGE(PG8_SB(0, 1), b2 + hstepB, voffB);
            PG8_WAIT_V(6); PG8_BAR; PG8_MMA(1, 1, At, B1); PG8_BAR;
            PG8_LDB(B0, 1, 0); PG8_SCHED; PG8_LDA(At, 1, 0); PG8_STAGE(PG8_SA(0, 1), a2 + hstepA, voffA);
            PG8_WAIT_L(8); PG8_BAR; PG8_WAIT_L(0); PG8_MMA(0, 0, At, B0); PG8_BAR; PG8_SCHED;
            PG8_LDB(B1, 1, 1); PG8_STAGE(PG8_SB(1, 0), b3, voffB);
            PG8_BAR; PG8_WAIT_L(0); PG8_MMA(0, 1, At, B1); PG8_BAR;
            PG8_LDA(At, 1, 1); PG8_STAGE(PG8_SA(1, 0), a3, voffA);
            PG8_BAR; PG8_WAIT_L(0); PG8_MMA(1, 0, At, B0); PG8_BAR; PG8_SCHED;
            PG8_STAGE(PG8_SB(1, 1), b3 + hstepB, voffB);
            PG8_WAIT_V(6); PG8_BAR; PG8_MMA(1, 1, At, B1); PG8_BAR;
            }
        }
        if constexpr (ALIGN_EPI) { if (wr == 0) PG8_BAR; }
        if constexpr (!Epi::AFTER_DRAIN) { E(acc, cur, wr, wc, fr, fq); S.done(cur); }
        if (!has_next) break;
#pragma unroll
        for (int a = 0; a < 2; ++a)
#pragma unroll
            for (int b = 0; b < 2; ++b)
#pragma unroll
                for (int m = 0; m < 4; ++m)
#pragma unroll
                    for (int n = 0; n < 2; ++n) acc[a][b][m][n] = (f32x4){0.f, 0.f, 0.f, 0.f};
        cur = nxt; cA = nA; cB = nB; ++ui;
        if constexpr (ALIGN_EPI) { if (wr == 1) PG8_BAR; }
    }
    PG8_WAIT_V(0);
    if constexpr (!ALIGN_EPI) { if (wr == 0) PG8_BAR; }
    PG8_BAR;
    if constexpr (Epi::AFTER_DRAIN) { E.fused(acc, cur, wr, wc, fr, fq, lds, wid, lane); S.done(cur); }
#undef PG8_SA
#undef PG8_SB
#undef PG8_STAGE
#undef PG8_LDA
#undef PG8_LDB
#undef PG8_MMA
#undef PG8_WAIT_V
#undef PG8_WAIT_L
#undef PG8_BAR
#undef PG8_SCHED
}
}

typedef unsigned short bf16_t;
typedef short bf16x8 __attribute__((ext_vector_type(8)));
typedef short s16x4 __attribute__((ext_vector_type(4)));
typedef float f32x4 __attribute__((ext_vector_type(4)));
typedef float f32x2 __attribute__((ext_vector_type(2)));
typedef float f32x16 __attribute__((ext_vector_type(16)));
typedef unsigned u32x4 __attribute__((ext_vector_type(4)));
typedef unsigned u32x2 __attribute__((ext_vector_type(2)));
#define LAS __attribute__((address_space(3)))

constexpr int NB = 8, SEQ = 4096, DM = 1024, DEPTH = 4, NMETA = 16, PADF = 112, TT = SEQ + NMETA, LP = TT + PADF;
constexpr int M = NB * LP;
constexpr int NPROJ = 1280, NUP = 1792, KUP = 384, NQ = 768, NKV = 1024, DFF = 2816, NGU = 2 * DFF, INC = 1184;
constexpr float LN_EPS = 1e-5f, RMS_EPS = 1e-6f, ALPHA = 1.681792830507429f, NEGF = -1e30f, LOG2E = 1.4426950408889634f;
constexpr float QS_MLA = 0.10206207261596577f * LOG2E;
constexpr float QS_SWA = 0.125f * LOG2E;
constexpr int NWAVES = 8, NTHR = 512;

constexpr size_t MiB = 1u << 20;
constexpr size_t WS_CTL = 0, WS_CS = 1 * MiB, WS_SSQ = 2 * MiB, WS_W = 4 * MiB, W_LAYER = 23 * MiB;
constexpr size_t WO_IN = 0, WO_UP = 5 * MiB / 2, WO_OUT = 4 * MiB, WO_GU = 6 * MiB, WO_DN = 17 * MiB;
constexpr size_t WS_HF = 96 * MiB, WS_HB = 228 * MiB, WS_P = 294 * MiB, WS_QA = WS_P + (size_t)M * NPROJ * 2, WS_KV = WS_QA + (size_t)M * NQ * 2, WS_END = WS_KV + (size_t)M * NKV * 2;
constexpr size_t WS_F = WS_P, WS_O = WS_HB;
static_assert(WS_W + 4 * W_LAYER <= WS_HF && WS_HF + (size_t)M * DM * 4 <= WS_HB && WS_HB + (size_t)M * DM * 2 <= WS_P && WS_F + (size_t)M * DFF * 2 <= WS_END && WS_END <= 512 * MiB, "ws map");
constexpr int LDS_BYTES = 147456;

__device__ __forceinline__ float wave_sum(float v) {
#pragma unroll
    for (int o = 1; o < 64; o <<= 1) v += __shfl_xor(v, o);
    return v;
}
__device__ __forceinline__ unsigned pk2(float lo, float hi) { f32x2 v = {lo, hi}; typedef __bf16 bf2 __attribute__((ext_vector_type(2))); bf2 b = __builtin_convertvector(v, bf2); return __builtin_bit_cast(unsigned, b); }
__device__ __forceinline__ float bf2f(unsigned short u) { return __uint_as_float((unsigned)u << 16); }

__device__ __forceinline__ void rope8(f32x4& x1, f32x4& x2, const float* cs, int row, int fq) {
    int t = row % LP - PADF; t = t < 0 ? 0 : t;
    const f32x4 c0 = *(const f32x4*)(cs + ((size_t)t * 16 + 4 * fq) * 2), c1 = *(const f32x4*)(cs + ((size_t)t * 16 + 4 * fq) * 2 + 4);
    const float co[4] = {c0[0], c0[2], c1[0], c1[2]}, si[4] = {c0[1], c0[3], c1[1], c1[3]};
#pragma unroll
    for (int j = 0; j < 4; ++j) { const float a = x1[j], b = x2[j]; x1[j] = a * co[j] - b * si[j]; x2[j] = b * co[j] + a * si[j]; }
}
__device__ __forceinline__ u32x4 pack8(const f32x4& v0, const f32x4& v1) { u32x4 w; w.x = pk2(v0[0], v0[1]); w.y = pk2(v0[2], v0[3]); w.z = pk2(v1[0], v1[1]); w.w = pk2(v1[2], v1[3]); return w; }

struct EpiInProj {
    static constexpr bool PERM = true, AFTER_DRAIN = false;
    bf16_t* P; float* ssq; const float* cs;
    __device__ __forceinline__ void operator()(const f32x4 (&acc)[2][2][4][2], const pg8::Unit& u, int wr, int wc, int fr, int fq) const {
        const int rowb = u.pm * 256 + wr * 64 + fr, pn = u.pn, colt = pn * 256 + wc * 32 + 8 * fq;
        const float sc = (pn == 2 || pn == 3) ? QS_SWA : 1.f;
#pragma unroll
        for (int ai = 0; ai < 2; ++ai)
#pragma unroll
            for (int m = 0; m < 4; ++m) {
                const int row = rowb + ai * 128 + m * 16; bf16_t* rowp = P + (size_t)row * NPROJ + colt; float ss[2];
#pragma unroll
                for (int bj = 0; bj < 2; ++bj) { f32x4 v0 = acc[ai][bj][m][0], v1 = acc[ai][bj][m][1];
                    if (pn == 1 && bj == 1 && wc == 0) rope8(v0, v1, cs, row, fq);
                    ss[bj] = (v0[0] * v0[0] + v0[1] * v0[1]) + (v0[2] * v0[2] + v0[3] * v0[3]) + (v1[0] * v1[0] + v1[1] * v1[1]) + (v1[2] * v1[2] + v1[3] * v1[3]);
                    v0 = v0 * sc; v1 = v1 * sc; *(u32x4*)(rowp + bj * 128) = pack8(v0, v1); }
                if (pn <= 1) { float s = (pn == 0) ? ss[0] + ss[1] : ss[0]; s += __shfl_xor(s, 16); s += __shfl_xor(s, 32); if (fq == 0) ssq[(size_t)row * 8 + pn * 4 + wc] = s; }
            }
    }
};
struct EpiUp {
    static constexpr bool PERM = true, AFTER_DRAIN = false;
    bf16_t* QA; bf16_t* KV; const float* ssq; const float* cs;
    __device__ __forceinline__ void operator()(const f32x4 (&acc)[2][2][4][2], const pg8::Unit& u, int wr, int wc, int fr, int fq) const {
        const int rowb = u.pm * 256 + wr * 64 + fr, pn = u.pn; const bool isq = pn < 3;
#pragma unroll
        for (int ai = 0; ai < 2; ++ai)
#pragma unroll
            for (int m = 0; m < 4; ++m) {
                const int row = rowb + ai * 128 + m * 16;
                const f32x4 sv = *(const f32x4*)(ssq + (size_t)row * 8 + (isq ? 0 : 4)); const float st = (sv[0] + sv[1]) + (sv[2] + sv[3]);
                const float rinv = isq ? QS_MLA / sqrtf(st * (1.f / 256.f) + RMS_EPS) : 1.f / sqrtf(st * (1.f / 128.f) + RMS_EPS);
                bf16_t* rowp = isq ? QA + (size_t)row * NQ + pn * 256 + wc * 32 + 8 * fq : KV + (size_t)row * NKV + (pn - 3) * 256 + wc * 32 + 8 * fq;
#pragma unroll
                for (int bj = 0; bj < 2; ++bj) { f32x4 v0 = acc[ai][bj][m][0], v1 = acc[ai][bj][m][1];
                    if (isq && ((8 * pn + 4 * bj + wc) % 3 == 2)) rope8(v0, v1, cs, row, fq);
                    v0 = v0 * rinv; v1 = v1 * rinv; *(u32x4*)(rowp + bj * 128) = pack8(v0, v1); }
            }
    }
};
struct EpiRes {
    static constexpr bool PERM = false, AFTER_DRAIN = false;
    float* Hf;
    __device__ __forceinline__ void operator()(const f32x4 (&acc)[2][2][4][2], const pg8::Unit& u, int wr, int wc, int fr, int fq) const {
        const int rowb = u.pm * 256 + wr * 64 + fr, col0 = u.pn * 256 + wc * 32 + 4 * fq;
#pragma unroll
        for (int ai = 0; ai < 2; ++ai)
#pragma unroll
            for (int m = 0; m < 4; ++m) { float* rowp = Hf + (size_t)(rowb + ai * 128 + m * 16) * DM + col0;
#pragma unroll
                for (int bj = 0; bj < 2; ++bj)
#pragma unroll
                    for (int n = 0; n < 2; ++n) { f32x4* p = (f32x4*)(rowp + bj * 128 + n * 16); *p = *p * ALPHA + acc[ai][bj][m][n]; } }
    }
};
__device__ __forceinline__ float silu_mul(float g, float u) { return g * __builtin_amdgcn_rcpf(1.f + __builtin_amdgcn_exp2f(-g * LOG2E)) * u; }
struct EpiSwiGLU {
    static constexpr bool PERM = true, AFTER_DRAIN = false;
    bf16_t* F;
    __device__ __forceinline__ void operator()(const f32x4 (&acc)[2][2][4][2], const pg8::Unit& u, int wr, int wc, int fr, int fq) const {
        const int rowb = u.pm * 256 + wr * 64 + fr, col0 = u.pn * 128 + wc * 32 + 8 * fq;
#pragma unroll
        for (int ai = 0; ai < 2; ++ai)
#pragma unroll
            for (int m = 0; m < 4; ++m) { f32x4 o0, o1;
#pragma unroll
                for (int j = 0; j < 4; ++j) { o0[j] = silu_mul(acc[ai][0][m][0][j], acc[ai][1][m][0][j]); o1[j] = silu_mul(acc[ai][0][m][1][j], acc[ai][1][m][1][j]); }
                *(u32x4*)(F + (size_t)(rowb + ai * 128 + m * 16) * DFF + col0) = pack8(o0, o1); }
    }
};

namespace att {
constexpr int KBUF = 64 * 208, VBUF = 8192, BUFB = KBUF + VBUF;
struct Src { const bf16_t* q; int qp; const bf16_t* k1; int k1p; const bf16_t* k2; int k2p; const bf16_t* v; int vp; bf16_t* o; int op; };
__device__ __forceinline__ int crow(int r, int hi) { return (r & 3) + 8 * (r >> 2) + 4 * hi; }
__device__ __forceinline__ s16x4 vtr(const LAS unsigned char* p) { typedef short v4 __attribute__((ext_vector_type(4))); return __builtin_bit_cast(s16x4, __builtin_amdgcn_ds_read_tr16_b64_v4i16((LAS v4*)p)); }
__device__ __forceinline__ bf16x8 packp(const f32x16& p, int s) { u32x4 w; w.x = pk2(p[8 * s], p[8 * s + 1]); w.y = pk2(p[8 * s + 2], p[8 * s + 3]); w.z = pk2(p[8 * s + 4], p[8 * s + 5]); w.w = pk2(p[8 * s + 6], p[8 * s + 7]); return __builtin_bit_cast(bf16x8, w); }

template <int DQK, bool SWA>
__device__ __forceinline__ void unit(LAS unsigned char* lds, const Src s, int j, float sinkl2, float cal) {
    constexpr int KSTR = DQK * 2 + 16, NDC = DQK / 16;
    const int tid = ltid(), lane = tid & 63, r32 = lane & 31, hi = lane >> 5; const int wid = __builtin_amdgcn_readfirstlane(tid >> 6);
    const int q0w = 256 * j - 128 + 32 * wid; const bool active = q0w >= 0;
    const int kt_hi = 4 * j + 1, kt_lo = SWA ? (4 * j - 4 > 1 ? 4 * j - 4 : 1) : 1, nt = kt_hi - kt_lo + 1;
    const int qrow = (q0w + r32) < 0 ? 0 : q0w + r32;
    bf16x8 qr[NDC];
#pragma unroll
    for (int dc = 0; dc < NDC; ++dc) qr[dc] = *(const bf16x8*)(s.q + (size_t)qrow * s.qp + dc * 16 + hi * 8);
    float m_run = SWA ? sinkl2 : NEGF, l_run = (SWA && hi == 0) ? 1.f : 0.f;
    f32x16 o0, o1;
#pragma unroll
    for (int r = 0; r < 16; ++r) { o0[r] = 0.f; o1[r] = 0.f; }
    const int key_l = tid >> 3, ch = tid & 7, key2 = tid >> 2, ch2 = tid & 3;
    u32x4 rk1, rk2, rv; rk2 = (u32x4){0u, 0u, 0u, 0u};
#define ATT_LOAD(kt) do { const size_t kr_ = (size_t)((kt) * 64 + key_l); rk1 = *(const u32x4*)(s.k1 + kr_ * s.k1p + ch * 8); rv = *(const u32x4*)(s.v + kr_ * s.vp + ch * 8); \
        if (DQK == 96 && tid < 256) rk2 = *(const u32x4*)(s.k2 + (size_t)((kt) * 64 + key2) * s.k2p + ch2 * 8); } while (0)
#define ATT_STORE(bo) do { *(LAS u32x4*)(lds + (bo) + key_l * KSTR + ch * 16) = rk1; *(LAS u32x4*)(lds + (bo) + KBUF + (ch >> 2) * 4096 + (key_l >> 3) * 512 + (key_l & 7) * 64 + (ch & 3) * 16) = rv; \
        if (DQK == 96 && tid < 256) *(LAS u32x4*)(lds + (bo) + key2 * KSTR + 128 + ch2 * 16) = rk2; } while (0)
    const int voff = KBUF + ((lane >> 4) & 1) * 32 + (lane & 3) * 8 + (4 * hi + ((lane & 15) >> 2)) * 64;
    ATT_LOAD(kt_lo); ATT_STORE(0); __syncthreads();
    for (int i = 0; i < nt; ++i) {
        const int kt = kt_lo + i, bo = (i & 1) * BUFB, kbase = kt * 64;
        if (i + 1 < nt) ATT_LOAD(kt + 1);
        const bool skip = !active || kbase > q0w + 31 || (SWA && kbase + 63 < q0w - 127);
        if (!skip) {
            f32x16 p0, p1;
#pragma unroll
            for (int r = 0; r < 16; ++r) { p0[r] = 0.f; p1[r] = 0.f; }
#pragma unroll
            for (int dc = 0; dc < NDC; ++dc) {
                const bf16x8 a0 = *(const LAS bf16x8*)(lds + bo + r32 * KSTR + dc * 32 + hi * 16);
                const bf16x8 a1 = *(const LAS bf16x8*)(lds + bo + (32 + r32) * KSTR + dc * 32 + hi * 16);
                p0 = __builtin_amdgcn_mfma_f32_32x32x16_bf16(a0, qr[dc], p0, 0, 0, 0);
                p1 = __builtin_amdgcn_mfma_f32_32x32x16_bf16(a1, qr[dc], p1, 0, 0, 0);
            }
            const int qpos = q0w + r32;
            const bool full = !SWA && kbase >= PADF && kbase + 63 <= q0w;
            if (!full) {
#pragma unroll
                for (int r = 0; r < 16; ++r) {
                    const int kp = kbase + crow(r, hi), d0_ = qpos - kp, d1_ = d0_ - 32;
                    const bool ok0 = d0_ >= 0 && kp >= PADF && (!SWA || d0_ < 128), ok1 = d1_ >= 0 && (kp + 32) >= PADF && (!SWA || d1_ < 128);
                    const float v0 = SWA ? p0[r] - cal * (float)d0_ : p0[r], v1 = SWA ? p1[r] - cal * (float)d1_ : p1[r];
                    p0[r] = ok0 ? v0 : NEGF; p1[r] = ok1 ? v1 : NEGF;
                }
            }
            float mx = fmaxf(p0[0], p1[0]);
#pragma unroll
            for (int r = 1; r < 16; ++r) mx = fmaxf(mx, fmaxf(p0[r], p1[r]));
            mx = fmaxf(mx, __shfl_xor(mx, 32));
            const float mn = fmaxf(m_run, mx), alpha = __builtin_amdgcn_exp2f(m_run - mn); m_run = mn;
            float ls = 0.f;
#pragma unroll
            for (int r = 0; r < 16; ++r) { p0[r] = __builtin_amdgcn_exp2f(p0[r] - mn); p1[r] = __builtin_amdgcn_exp2f(p1[r] - mn); ls += p0[r] + p1[r]; }
            l_run = l_run * alpha + ls;
#pragma unroll
            for (int r = 0; r < 16; ++r) { o0[r] *= alpha; o1[r] *= alpha; }
            const LAS unsigned char* vb = lds + bo + voff;
#pragma unroll
            for (int c2 = 0; c2 < 2; ++c2)
#pragma unroll
                for (int s2 = 0; s2 < 2; ++s2) {
                    const bf16x8 pf = packp(c2 ? p1 : p0, s2);
                    const int ko = (4 * c2 + 2 * s2) * 512;
                    const s16x4 a = vtr(vb + ko), b = vtr(vb + ko + 512), c = vtr(vb + 4096 + ko), d = vtr(vb + 4096 + ko + 512);
                    const bf16x8 v0 = {a[0], a[1], a[2], a[3], b[0], b[1], b[2], b[3]}, v1 = {c[0], c[1], c[2], c[3], d[0], d[1], d[2], d[3]};
                    o0 = __builtin_amdgcn_mfma_f32_32x32x16_bf16(v0, pf, o0, 0, 0, 0);
                    o1 = __builtin_amdgcn_mfma_f32_32x32x16_bf16(v1, pf, o1, 0, 0, 0);
                }
        }
        if (i + 1 < nt) ATT_STORE(((i + 1) & 1) * BUFB);
        __syncthreads();
    }
#undef ATT_LOAD
#undef ATT_STORE
    const float lt = l_run + __shfl_xor(l_run, 32), inv = lt > 0.f ? 1.f / lt : 0.f;
    if (active) {
        bf16_t* op = s.o + (size_t)(q0w + r32) * s.op + 4 * hi;
#pragma unroll
        for (int g = 0; g < 4; ++g) {
            u32x2 w0, w1; w0.x = pk2(o0[4 * g] * inv, o0[4 * g + 1] * inv); w0.y = pk2(o0[4 * g + 2] * inv, o0[4 * g + 3] * inv);
            w1.x = pk2(o1[4 * g] * inv, o1[4 * g + 1] * inv); w1.y = pk2(o1[4 * g + 2] * inv, o1[4 * g + 3] * inv);
            *(u32x2*)(op + 8 * g) = w0; *(u32x2*)(op + 32 + 8 * g) = w1;
        }
    }
}
}

__device__ __forceinline__ void ln_store(f32x4 (&v)[4], const float* g, const float* b, float* of32, bf16_t* ob, float* out2, int lane) {
    float s = 0.f;
#pragma unroll
    for (int j = 0; j < 4; ++j) s += (v[j][0] + v[j][1]) + (v[j][2] + v[j][3]);
    const float mean = wave_sum(s) * (1.f / DM); float s2 = 0.f;
#pragma unroll
    for (int j = 0; j < 4; ++j) { v[j] = v[j] - mean; s2 += (v[j][0] * v[j][0] + v[j][1] * v[j][1]) + (v[j][2] * v[j][2] + v[j][3] * v[j][3]); }
    const float rstd = 1.f / sqrtf(wave_sum(s2) * (1.f / DM) + LN_EPS);
#pragma unroll
    for (int j = 0; j < 4; ++j) { const int c = 4 * (lane + 64 * j); const f32x4 gv = *(const f32x4*)(g + c), bv = *(const f32x4*)(b + c); const f32x4 o = v[j] * rstd * gv + bv;
        *(f32x4*)(of32 + c) = o; u32x2 w; w.x = pk2(o[0], o[1]); w.y = pk2(o[2], o[3]); *(u32x2*)(ob + c) = w; if (out2) *(f32x4*)(out2 + c) = o; }
}

__device__ __forceinline__ int rope_perm(int p) { return 16 * ((p >> 2) & 1) + 4 * (p >> 3) + (p & 3); }
__device__ __forceinline__ void wt_item(const float* W, int ldw, int kind, int koff, int kval, const float* g0, const float* g1, bf16_t* dst, int Kd, int drow0, int k0, int n0, LAS float* scr, int lane) {
    const int n = n0 + (lane & 31); int sc;
    if (kind == 0) sc = n < 384 ? n : (n < 416 ? 384 + rope_perm(n - 384) : (n < 512 ? -1 : n - 96));
    else if (kind == 1) { const int hd = n / 96, w = n % 96; sc = w < 64 ? n : hd * 96 + 64 + rope_perm(w - 64); }
    else if (kind == 4) sc = ((n >> 7) & 1) * DFF + 128 * (n >> 8) + (n & 127);
    else sc = n;
#pragma unroll 8
    for (int i = 0; i < 32; ++i) { const int kk = 2 * i + (lane >> 5), ks = k0 + kk - koff; float v = 0.f;
        if (ks >= 0 && ks < kval && sc >= 0) { v = W[(size_t)ks * ldw + sc]; if (g0) v *= (g1 && ks >= 512) ? g1[ks - 512] : g0[ks]; }
        scr[kk * 33 + (lane & 31)] = v; }
    asm volatile("s_waitcnt lgkmcnt(0)" ::: "memory");
    const int c = lane & 7;
#pragma unroll
    for (int j = 0; j < 4; ++j) { const int nn = (lane >> 3) + 8 * j; const LAS float* s = scr + (8 * c) * 33 + nn;
        u32x4 o; o.x = pk2(s[0 * 33], s[1 * 33]); o.y = pk2(s[2 * 33], s[3 * 33]); o.z = pk2(s[4 * 33], s[5 * 33]); o.w = pk2(s[6 * 33], s[7 * 33]);
        *(u32x4*)(dst + (size_t)(drow0 + n0 + nn) * Kd + k0 + 8 * c) = o; }
    asm volatile("s_waitcnt lgkmcnt(0)" ::: "memory");
}

struct Args { const float* in[19]; float* out; unsigned char* ws; int ph_lo, ph_hi; };
constexpr int NPHASE = 1 + 9 * DEPTH;
constexpr int IT_IN = 16 * 40, IT_UQ = 6 * 24, IT_UKV = 6 * 32, IT_OUT = 16 * 32, IT_GU = 16 * 176, IT_DN = 44 * 32, IT_LAYER = IT_IN + IT_UQ + IT_UKV + IT_OUT + IT_GU + IT_DN;

__device__ __forceinline__ const void* karg(int byteoff) { const void* r; asm volatile("s_load_dwordx2 %0, %1, %2\n\ts_waitcnt lgkmcnt(0)" : "=s"(r) : "s"(__builtin_amdgcn_kernarg_segment_ptr()), "n"(byteoff)); return r; }
#define KIN(i) ((const float*)karg(8 * (i)))
#define KOUT ((float*)karg(152))
#define KWS ((unsigned char*)karg(160))
__global__ void __launch_bounds__(NTHR, 2) fwd(Args a) {
    extern __shared__ __attribute__((aligned(16))) unsigned char lds_raw[];
    LAS unsigned char* lds = (LAS unsigned char*)lds_raw;
    for (int ph = a.ph_lo; ph < a.ph_hi; ++ph) {
        unsigned char* ws = KWS;
        const int tid = ltid(), lane = tid & 63, wave = __builtin_amdgcn_readfirstlane(tid >> 6);
        const int G = lgrid(), bid = lbid(), gw = bid * NWAVES + wave, NGW = G * NWAVES;
#define CS ((float*)(ws + WS_CS))
#define SSQ ((float*)(ws + WS_SSQ))
#define Hf ((float*)(ws + WS_HF))
#define Hb ((bf16_t*)(ws + WS_HB))
#define Ob ((bf16_t*)(ws + WS_O))
#define P ((bf16_t*)(ws + WS_P))
#define QA ((bf16_t*)(ws + WS_QA))
#define KV ((bf16_t*)(ws + WS_KV))
#define Fb ((bf16_t*)(ws + WS_F))
        if (ph == 0 && EN(9)) {
            LAS float* scr = (LAS float*)(lds + wave * 16384);
            for (int it = gw; it < DEPTH * IT_LAYER; it += NGW) {
                const int l = it / IT_LAYER; int r = it % IT_LAYER; unsigned char* wl = ws + WS_W + (size_t)l * W_LAYER;
                if (r < IT_IN) { wt_item(KIN(4) + (size_t)l * DM * INC, INC, 0, 0, DM, nullptr, nullptr, (bf16_t*)(wl + WO_IN), DM, 0, 64 * (r / 40), 32 * (r % 40), scr, lane); continue; } r -= IT_IN;
                if (r < IT_UQ) { wt_item(KIN(6) + (size_t)l * 256 * NQ, NQ, 1, 0, 256, KIN(5) + l * 256, nullptr, (bf16_t*)(wl + WO_UP), KUP, 0, 64 * (r / 24), 32 * (r % 24), scr, lane); continue; } r -= IT_UQ;
                if (r < IT_UKV) { wt_item(KIN(8) + (size_t)l * 128 * NKV, NKV, 2, 256, 128, KIN(7) + l * 128, nullptr, (bf16_t*)(wl + WO_UP), KUP, NQ, 64 * (r / 32), 32 * (r % 32), scr, lane); continue; } r -= IT_UKV;
                if (r < IT_OUT) { wt_item(KIN(12) + (size_t)l * DM * DM, DM, 3, 0, DM, KIN(10) + l * 512, KIN(11) + l * 512, (bf16_t*)(wl + WO_OUT), DM, 0, 64 * (r / 32), 32 * (r % 32), scr, lane); continue; } r -= IT_OUT;
                if (r < IT_GU) { wt_item(KIN(15) + (size_t)l * DM * NGU, NGU, 4, 0, DM, nullptr, nullptr, (bf16_t*)(wl + WO_GU), DM, 0, 64 * (r / 176), 32 * (r % 176), scr, lane); continue; } r -= IT_GU;
                wt_item(KIN(16) + (size_t)l * DFF * DM, DM, 5, 0, DFF, nullptr, nullptr, (bf16_t*)(wl + WO_DN), DFF, 0, 64 * (r / 32), 32 * (r % 32), scr, lane);
            }
            for (int e = bid * NTHR + tid; e < TT * 16; e += G * NTHR) {
                const int t = e >> 4, i = e & 15; const float inv = exp2f(-(float)i * 0.8304820237218406f); const float ang = (float)t * inv;
                double rev = (double)ang * 0.15915494309189535; rev -= floor(rev); const float rf = (float)rev;
                CS[2 * e] = __builtin_amdgcn_cosf(rf); CS[2 * e + 1] = __builtin_amdgcn_sinf(rf);
            }
            for (int m = gw; m < M; m += NGW) {
                const int b = m / LP, pp = m % LP; float* of = Hf + (size_t)m * DM; bf16_t* ob = Hb + (size_t)m * DM;
                if (pp < PADF) {
#pragma unroll
                    for (int j = 0; j < 4; ++j) { const int c = 4 * (lane + 64 * j); *(f32x4*)(of + c) = (f32x4){0.f, 0.f, 0.f, 0.f}; *(u32x2*)(ob + c) = (u32x2){0u, 0u}; }
                } else {
                    const float* src = pp < PADF + NMETA ? KIN(1) + (size_t)(pp - PADF) * DM : KIN(0) + ((size_t)b * SEQ + (pp - PADF - NMETA)) * DM;
                    f32x4 v[4];
#pragma unroll
                    for (int j = 0; j < 4; ++j) v[j] = *(const f32x4*)(src + 4 * (lane + 64 * j));
                    ln_store(v, KIN(2), KIN(3), of, ob, nullptr, lane);
                }
            }
        } else {
            const int l = (ph - 1) / 9, st = (ph - 1) % 9; unsigned char* wl = ws + WS_W + (size_t)l * W_LAYER;
            if (st == 0 && EN(0)) {
                pg8::Gemm g{Hb, (const bf16_t*)(wl + WO_IN), M, NPROJ, DM, DM}; pg8::StaticOrder S; S.init(M, NPROJ, G, (int)bid);
                EpiInProj E{P, SSQ, CS};
                pg8::gemm_phase<EpiInProj, pg8::StaticOrder, true, true>(lds, g, S, E);
            } else if (st == 1 && EN(1)) {
                pg8::Gemm g{P, (const bf16_t*)(wl + WO_UP), M, NUP, KUP, NPROJ}; pg8::StaticOrder S; S.init(M, NUP, G, (int)bid);
                EpiUp E{QA, KV, SSQ, CS};
                pg8::gemm_phase<EpiUp, pg8::StaticOrder, true, true>(lds, g, S, E);
            } else if (st == 2 && EN(2)) {
                for (int vc = bid; vc < 256; vc += G) {
                    const int gq = vc >> 6, bh = vc & 63, b = bh >> 3, h = bh & 7;
                    { att::Src s; s.q = QA + (size_t)b * LP * NQ + h * 96; s.qp = NQ; s.k1 = KV + (size_t)b * LP * NKV + h * 128; s.k1p = NKV; s.k2 = P + (size_t)b * LP * NPROJ + 384; s.k2p = NPROJ;
                      s.v = s.k1 + 64; s.vp = NKV; s.o = Ob + (size_t)b * LP * DM + h * 64; s.op = DM;
                      const int nm = gq == 0 ? 5 : 4;
                      for (int i = 0; i < nm; ++i) { const int j = i == 0 ? 16 - gq : (i == 1 ? 9 + gq : (i == 2 ? 8 - gq : (i == 3 ? 1 + gq : 0))); att::unit<96, false>(lds, s, j, 0.f, 0.f); } }
                    const int ns = (vc >= 64 && vc < 128) ? 5 : 4;
                    for (int i = 0; i < ns; ++i) { const int u = i < 4 ? vc + 256 * i : 1024 + (vc - 64); const int j = u >> 6, b2 = (u & 63) >> 3, hq = u & 7, kvh = hq >> 2;
                        att::Src s; const bf16_t* pb = P + (size_t)b2 * LP * NPROJ; s.q = pb + 512 + 64 * hq; s.qp = NPROJ; s.k1 = pb + 1024 + 64 * kvh; s.k1p = NPROJ; s.k2 = pb; s.k2p = NPROJ; s.v = pb + 1152 + 64 * kvh; s.vp = NPROJ;
                        s.o = Ob + (size_t)b2 * LP * DM + 512 + 64 * hq; s.op = DM;
                        att::unit<64, true>(lds, s, j, KIN(9)[l * 8 + hq] * LOG2E, exp2f(-(float)(hq + 1)) * LOG2E); }
                }
            } else if (st == 3 && EN(3)) {
                for (int m = gw; m < M; m += NGW) { u32x4* rp = (u32x4*)(Ob + (size_t)m * DM) + lane; u32x4 x0 = rp[0], x1 = rp[64]; float s0 = 0.f, s1 = 0.f;
#pragma unroll
                    for (int e = 0; e < 4; ++e) { const float a0 = __uint_as_float(x0[e] << 16), a1 = __uint_as_float(x0[e] & 0xffff0000u), b0 = __uint_as_float(x1[e] << 16), b1 = __uint_as_float(x1[e] & 0xffff0000u); s0 += a0 * a0 + a1 * a1; s1 += b0 * b0 + b1 * b1; }
                    const float r0 = 1.f / sqrtf(wave_sum(s0) * (1.f / 512.f) + RMS_EPS), r1 = 1.f / sqrtf(wave_sum(s1) * (1.f / 512.f) + RMS_EPS);
#pragma unroll
                    for (int e = 0; e < 4; ++e) { x0[e] = pk2(__uint_as_float(x0[e] << 16) * r0, __uint_as_float(x0[e] & 0xffff0000u) * r0); x1[e] = pk2(__uint_as_float(x1[e] << 16) * r1, __uint_as_float(x1[e] & 0xffff0000u) * r1); }
                    rp[0] = x0; rp[64] = x1; }
            } else if (st == 4 && EN(4)) {
                pg8::Gemm g{Ob, (const bf16_t*)(wl + WO_OUT), M, DM, DM, DM}; pg8::StaticOrder S; S.init(M, DM, G, (int)bid);
                EpiRes E{Hf};
                pg8::gemm_phase<EpiRes, pg8::StaticOrder, true, true>(lds, g, S, E);
            } else if ((st == 5 || st == 8) && EN(5)) {
                const float* gg = (st == 5 ? KIN(13) : KIN(17)) + l * DM; const float* bb = (st == 5 ? KIN(14) : KIN(18)) + l * DM; const bool fin = (l == DEPTH - 1 && st == 8);
                for (int m = gw; m < M; m += NGW) { float* of = Hf + (size_t)m * DM; f32x4 v[4];
#pragma unroll
                    for (int j = 0; j < 4; ++j) v[j] = *(const f32x4*)(of + 4 * (lane + 64 * j));
                    const int b = m / LP, pp = m % LP; float* o2 = (fin && pp >= PADF + NMETA) ? KOUT + ((size_t)b * SEQ + (pp - PADF - NMETA)) * DM : nullptr;
                    ln_store(v, gg, bb, of, Hb + (size_t)m * DM, o2, lane); }
            } else if (st == 6 && EN(6)) {
                pg8::Gemm g{Hb, (const bf16_t*)(wl + WO_GU), M, NGU, DM, DM}; pg8::StaticOrder S; S.init(M, NGU, G, (int)bid);
                EpiSwiGLU E{Fb};
                pg8::gemm_phase<EpiSwiGLU, pg8::StaticOrder, true, true>(lds, g, S, E);
            } else if (EN(7)) {
                pg8::Gemm g{Fb, (const bf16_t*)(wl + WO_DN), M, DM, DFF, DFF}; pg8::StaticOrder S; S.init(M, DM, G, (int)bid);
                EpiRes E{Hf};
                pg8::gemm_phase<EpiRes, pg8::StaticOrder, true, true>(lds, g, S, E);
            }
        }
        if (ph + 1 < a.ph_hi) { cg::this_grid().sync(); }
    }
}

extern "C" void kernel_launch(void* const* d_in, const int* in_sizes, int n_in, void* d_out, int out_size, void* d_ws, size_t ws_size, hipStream_t stream) {
    static int grid = 0;
    if (grid == 0) {
        if (n_in != 19 || ws_size < WS_END) { fprintf(stderr, "kernel_launch: unexpected n_in %d / ws_size %zu (need %zu)\n", n_in, ws_size, (size_t)WS_END); grid = -1; return; }
        int dev = 0, cus = 0, per_cu = 0;
        hipGetDevice(&dev); hipDeviceGetAttribute(&cus, hipDeviceAttributeMultiprocessorCount, dev);
        if (hipFuncSetAttribute((const void*)fwd, hipFuncAttributeMaxDynamicSharedMemorySize, LDS_BYTES) != hipSuccess) { fprintf(stderr, "kernel_launch: hipFuncSetAttribute failed\n"); grid = -1; return; }
        if (hipOccupancyMaxActiveBlocksPerMultiprocessor(&per_cu, (const void*)fwd, NTHR, LDS_BYTES) != hipSuccess || per_cu < 1) per_cu = 1;
        (void)hipGetLastError();
        grid = cus * per_cu; if (grid <= 0) grid = 256;
    }
    if (grid < 0) return;
    Args a{};
    for (int i = 0; i < 19; ++i) a.in[i] = (const float*)d_in[i];
    a.out = (float*)d_out; a.ws = (unsigned char*)d_ws;
#if MK_SINGLE
    a.ph_lo = 0; a.ph_hi = NPHASE;
    void* args[] = {&a};
    hipError_t e = hipLaunchCooperativeKernel((const void*)fwd, dim3(grid), dim3(NTHR), args, LDS_BYTES, stream);
    if (e != hipSuccess) fprintf(stderr, "cooperative launch failed: %s (grid %d)\n", hipGetErrorString(e), grid);
#else
    for (int ph = 0; ph < NPHASE; ++ph) { a.ph_lo = ph; a.ph_hi = ph + 1; hipLaunchKernelGGL(fwd, dim3(grid), dim3(NTHR), LDS_BYTES, stream, a); }
#endif
}
```
